# Optimizing an MI355X kernel written in HIP

```python
import jax, jax.numpy as jnp
from jax import lax
import numpy as np

D_MODEL = 1024
BATCH = 8
SEQ = 4096
DEPTH = 1

MLA_HEADS = 8
MLA_NOPE_DIM = 64
MLA_ROPE_DIM = 32
MLA_V_DIM = 64
MLA_Q_RANK = 384
MLA_KV_RANK = 256
MLA_QK_DIM = MLA_NOPE_DIM + MLA_ROPE_DIM
RET_HEADS = 4
RET_QK_DIM = 64
RET_V_DIM = 128
CHUNK = 128
Q_BLOCK = 128

MLA_WIDTH = MLA_HEADS * MLA_V_DIM
RET_WIDTH = RET_HEADS * RET_V_DIM
D_MIX = MLA_WIDTH + RET_WIDTH
IN_SPLITS = (MLA_Q_RANK, MLA_KV_RANK, MLA_ROPE_DIM,
             RET_HEADS * RET_QK_DIM, RET_HEADS * RET_QK_DIM, RET_WIDTH, RET_WIDTH)
IN_COLS = sum(IN_SPLITS)
D_FF = ((8 * D_MODEL + 3 * 256 - 1) // (3 * 256)) * 256
ROPE_BASE = 10000.0
EPS = 1e-6

kernel_name = "hybrid_mla_retention_sandwich_adaln"


def rmsnorm(x, g):
    x32 = x.astype(jnp.float32)
    r = x32 * lax.rsqrt(jnp.mean(x32 * x32, axis=-1, keepdims=True) + EPS)
    return (r * g.astype(jnp.float32)).astype(x.dtype)


def rope(x, pos):
    d = x.shape[-1]
    inv = ROPE_BASE ** (-jnp.arange(0, d, 2, dtype=jnp.float32) / d)
    ang = pos.astype(jnp.float32)[:, :, None, None] * inv
    cos, sin = jnp.cos(ang), jnp.sin(ang)
    x1, x2 = jnp.split(x.astype(jnp.float32), 2, axis=-1)
    return jnp.concatenate([x1 * cos - x2 * sin, x1 * sin + x2 * cos], axis=-1).astype(x.dtype)


def mla_group(cq_raw, ckv_raw, kpe_raw, pos, q_a_norm, w_q_b, kv_a_norm, w_kv_b):
    B, S, _ = cq_raw.shape
    cq = rmsnorm(cq_raw, q_a_norm)
    q = (cq @ w_q_b).reshape(B, S, MLA_HEADS, MLA_QK_DIM)
    q_nope, q_pe = q[..., :MLA_NOPE_DIM], rope(q[..., MLA_NOPE_DIM:], pos)
    ckv = rmsnorm(ckv_raw, kv_a_norm)
    kv = (ckv @ w_kv_b).reshape(B, S, MLA_HEADS, MLA_NOPE_DIM + MLA_V_DIM)
    k_nope, v = kv[..., :MLA_NOPE_DIM], kv[..., MLA_NOPE_DIM:]
    k_pe = rope(kpe_raw[:, :, None, :], pos)
    q = jnp.concatenate([q_nope, q_pe], axis=-1)
    k = jnp.concatenate([k_nope, jnp.broadcast_to(k_pe, (B, S, MLA_HEADS, MLA_ROPE_DIM))], axis=-1)
    scale = MLA_QK_DIM ** -0.5
    nb = S // Q_BLOCK
    qb = q.reshape(B, nb, Q_BLOCK, MLA_HEADS, MLA_QK_DIM).transpose(1, 0, 3, 2, 4)
    kt = k.transpose(0, 2, 1, 3)
    vt = v.transpose(0, 2, 1, 3)
    k_idx = jnp.arange(S)

    def block(args):
        q_blk, start = args
        s = jnp.einsum('bhqd,bhkd->bhqk', q_blk, kt, preferred_element_type=jnp.float32) * scale
        q_idx = start + jnp.arange(Q_BLOCK)
        s = jnp.where(k_idx[None, :] <= q_idx[:, None], s, -jnp.inf)
        p = jax.nn.softmax(s, axis=-1).astype(vt.dtype)
        return jnp.einsum('bhqk,bhkd->bhqd', p, vt)

    o = lax.map(block, (qb, jnp.arange(nb) * Q_BLOCK))
    return o.transpose(1, 0, 3, 2, 4).reshape(B, S, MLA_WIDTH)


def retention_group(q_raw, k_raw, v_raw, g_raw, pos, gn_gain):
    B, S, _ = q_raw.shape
    f32 = jnp.float32
    q = rope(q_raw.reshape(B, S, RET_HEADS, RET_QK_DIM), pos).astype(f32)
    k = rope(k_raw.reshape(B, S, RET_HEADS, RET_QK_DIM), pos).astype(f32) * (RET_QK_DIM ** -0.5)
    v = v_raw.reshape(B, S, RET_HEADS, RET_V_DIM).astype(f32)
    log_gamma = jnp.log(1.0 - 2.0 ** (-5.0 - jnp.arange(RET_HEADS, dtype=f32)))
    nc = S // CHUNK
    to_chunks = lambda t: t.reshape(B, nc, CHUNK, RET_HEADS, t.shape[-1]).transpose(0, 3, 1, 2, 4)
    qc, kc, vc = to_chunks(q), to_chunks(k), to_chunks(v)
    idx = jnp.arange(CHUNK)
    rel = idx[:, None] - idx[None, :]
    decay_in = jnp.where(rel >= 0, jnp.exp(log_gamma[:, None, None] * jnp.maximum(rel, 0).astype(f32)), 0.0)
    scores = jnp.einsum('bhncd,bhnmd->bhncm', qc, kc) * decay_in[None, :, None]
    inner = jnp.einsum('bhncm,bhnmv->bhncv', scores, vc)
    w_k = jnp.exp(log_gamma[:, None] * (CHUNK - 1 - idx).astype(f32))
    u = jnp.einsum('bhncd,bhnce->bhnde', kc * w_k[None, :, None, :, None], vc)
    chunk_decay = jnp.exp(log_gamma * CHUNK)[None, :, None, None]

    def step(state, u_i):
        return state * chunk_decay + u_i, state

    _, s_prev = lax.scan(step, jnp.zeros((B, RET_HEADS, RET_QK_DIM, RET_V_DIM), f32),
                         u.transpose(2, 0, 1, 3, 4))
    s_prev = s_prev.transpose(1, 2, 0, 3, 4)
    w_q = jnp.exp(log_gamma[:, None] * (idx + 1).astype(f32))
    cross = jnp.einsum('bhncd,bhnde->bhnce', qc * w_q[None, :, None, :, None], s_prev)
    o = (inner + cross).transpose(0, 2, 3, 1, 4).reshape(B, S, RET_HEADS, RET_V_DIM)
    mu = jnp.mean(o, axis=-1, keepdims=True)
    var = jnp.mean(jnp.square(o - mu), axis=-1, keepdims=True)
    o = ((o - mu) * lax.rsqrt(var + EPS)).reshape(B, S, RET_WIDTH) * gn_gain.astype(f32)
    return (jax.nn.silu(g_raw.astype(f32)) * o).astype(q_raw.dtype)


def setup_inputs(seed: int = 0) -> dict:
    key = jax.random.key(seed)
    ks = jax.random.split(key, 24)
    L = DEPTH
    nrm = lambda k, shape, fan_in: jax.random.normal(k, shape, jnp.float32) * fan_in ** -0.5
    gain = lambda k, n: 1.0 + 0.05 * jax.random.normal(k, (L, n), jnp.float32)
    return {
        "x": jax.random.normal(ks[0], (BATCH, SEQ, D_MODEL), jnp.float32),
        "c": jax.random.normal(ks[1], (BATCH, D_MODEL), jnp.float32),
        "positions": (jax.random.randint(ks[2], (BATCH, 1), 0, 512, jnp.int32)
                      + jnp.arange(SEQ, dtype=jnp.int32)[None, :]),
        "w_ada": 0.5 * nrm(ks[3], (L, D_MODEL, 6 * D_MODEL), D_MODEL),
        "b_ada": 0.01 * jax.random.normal(ks[4], (L, 6 * D_MODEL), jnp.float32),
        "pre_norm_mix": gain(ks[5], D_MODEL),
        "w_in": nrm(ks[6], (L, D_MODEL, IN_COLS), D_MODEL),
        "q_a_norm": gain(ks[7], MLA_Q_RANK),
        "w_q_b": nrm(ks[8], (L, MLA_Q_RANK, MLA_HEADS * MLA_QK_DIM), MLA_Q_RANK),
        "kv_a_norm": gain(ks[9], MLA_KV_RANK),
        "w_kv_b": nrm(ks[10], (L, MLA_KV_RANK, MLA_HEADS * (MLA_NOPE_DIM + MLA_V_DIM)), MLA_KV_RANK),
        "mla_out_norm": gain(ks[11], MLA_WIDTH),
        "ret_gn_gain": gain(ks[12], RET_WIDTH),
        "w_out": nrm(ks[13], (L, D_MIX, D_MODEL), D_MIX),
        "post_norm_mix": gain(ks[14], D_MODEL),
        "pre_norm_ffn": gain(ks[15], D_MODEL),
        "w_gate": nrm(ks[16], (L, D_MODEL, D_FF), D_MODEL),
        "w_up": nrm(ks[17], (L, D_MODEL, D_FF), D_MODEL),
        "w_down": nrm(ks[18], (L, D_FF, D_MODEL), D_FF),
        "post_norm_ffn": gain(ks[19], D_MODEL),
    }


def reference(x, c, positions, w_ada, b_ada, pre_norm_mix, w_in, q_a_norm, w_q_b, kv_a_norm,
              w_kv_b, mla_out_norm, ret_gn_gain, w_out, post_norm_mix, pre_norm_ffn,
              w_gate, w_up, w_down, post_norm_ffn):
    offsets = np.cumsum(IN_SPLITS)[:-1].tolist()
    for l in range(DEPTH):
        mod = (jax.nn.silu(c) @ w_ada[l] + b_ada[l])[:, None, :]
        sh1, sc1, g1, sh2, sc2, g2 = jnp.split(mod, 6, axis=-1)
        h = rmsnorm(x, pre_norm_mix[l]) * (1.0 + sc1) + sh1
        z = h @ w_in[l]
        cq, ckv, kpe, rq, rk, rv, rg = jnp.split(z, offsets, axis=-1)
        y_mla = rmsnorm(mla_group(cq, ckv, kpe, positions, q_a_norm[l], w_q_b[l],
                                  kv_a_norm[l], w_kv_b[l]), mla_out_norm[l])
        y_ret = retention_group(rq, rk, rv, rg, positions, ret_gn_gain[l])
        mix = jnp.concatenate([y_mla, y_ret], axis=-1) @ w_out[l]
        x = x + g1 * rmsnorm(mix, post_norm_mix[l])
        h = rmsnorm(x, pre_norm_ffn[l]) * (1.0 + sc2) + sh2
        f = (jax.nn.silu(h @ w_gate[l]) * (h @ w_up[l])) @ w_down[l]
        x = x + g2 * rmsnorm(f, post_norm_ffn[l])
    return x
```

```cpp
#include <hip/hip_runtime.h>
#include <cstdint>
#include <cstdio>

constexpr int BATCH = 8, SEQ = 4096, DM = 1024, T = BATCH * SEQ;
constexpr int QR = 384, KVR = 256, NH = 8, DN = 64, DR = 32, DV = 64, DQK = 96;
constexpr int RH = 4, RDK = 64, RDV = 128;
constexpr int INC = 2208, DFF = 2816;
constexpr float EPS = 1e-6f;
constexpr float QSCALE = 0.10206207261596577f * 1.4426950408889634f;

typedef unsigned short bf16_t;
__device__ __forceinline__ float bf2f(bf16_t v) { return __uint_as_float((unsigned)v << 16); }
__device__ __forceinline__ bf16_t f2bf(float f) { unsigned u = __float_as_uint(f); return (bf16_t)((u + 0x7fffu + ((u >> 16) & 1u)) >> 16); }

constexpr size_t MiB = 1u << 20;
constexpr size_t WS_CTL = 0;
constexpr size_t WS_MOD = 1 * MiB;
constexpr size_t WS_WIN = 2 * MiB, WS_WQ = 7 * MiB, WS_WKV = 8 * MiB, WS_WOUT = 9 * MiB, WS_WGU = 11 * MiB, WS_WDN = 22 * MiB;
constexpr size_t WS_ROPE = 28 * MiB;
constexpr size_t WS_SSCQ = 36 * MiB, WS_SSCKV = 37 * MiB, WS_SSO = 38 * MiB;
constexpr size_t WS_XCH = 39 * MiB;
constexpr size_t WS_KPE = 44 * MiB;
constexpr size_t WS_H = 48 * MiB;
constexpr size_t WS_Y = 112 * MiB;
constexpr size_t WS_ACT = 176 * MiB;
constexpr size_t WS_CQ = 176 * MiB, WS_CKV = 200 * MiB, WS_RQ = 216 * MiB, WS_RK = 232 * MiB, WS_RV = 248 * MiB, WS_RG = 280 * MiB;
constexpr size_t WS_Q = 352 * MiB, WS_K = 400 * MiB, WS_V = 448 * MiB, WS_END = 480 * MiB;
constexpr size_t WS_MIXTMP = 176 * MiB;
constexpr size_t WS_FTMP = 352 * MiB;

__global__ void __launch_bounds__(256) k_mod(const float* __restrict__ c, const float* __restrict__ w_ada, const float* __restrict__ b_ada, float* __restrict__ mod) {
    const int j = blockIdx.x * 256 + threadIdx.x, b = blockIdx.y;
    __shared__ float sc[1024];
    for (int k = threadIdx.x; k < 1024; k += 256) { const float v = c[b * 1024 + k]; sc[k] = v / (1.f + expf(-v)); }
    __syncthreads();
    float acc = 0.f;
    for (int k = 0; k < 1024; ++k) acc = fmaf(sc[k], w_ada[(size_t)k * 6144 + j], acc);
    mod[b * 6144 + j] = acc + b_ada[j];
}

__device__ __forceinline__ void sincos_f32arg(float ang, float& cs, float& sn) {
    const double a = (double)ang;
    const double kd = __builtin_rint(a * 0.63661977236758134308);
    double r = __builtin_fma(-kd, 1.57079632679489655800e+00, a);
    r = __builtin_fma(-kd, 6.12323399573676603587e-17, r);
    const double r2 = r * r;
    double s = -1.0 / 1307674368000.0;
    s = __builtin_fma(s, r2, 1.0 / 6227020800.0);
    s = __builtin_fma(s, r2, -1.0 / 39916800.0);
    s = __builtin_fma(s, r2, 1.0 / 362880.0);
    s = __builtin_fma(s, r2, -1.0 / 5040.0);
    s = __builtin_fma(s, r2, 1.0 / 120.0);
    s = __builtin_fma(s, r2, -1.0 / 6.0);
    s = __builtin_fma(s * r2, r, r);
    double co = 1.0 / 20922789888000.0;
    co = __builtin_fma(co, r2, -1.0 / 87178291200.0);
    co = __builtin_fma(co, r2, 1.0 / 479001600.0);
    co = __builtin_fma(co, r2, -1.0 / 3628800.0);
    co = __builtin_fma(co, r2, 1.0 / 40320.0);
    co = __builtin_fma(co, r2, -1.0 / 720.0);
    co = __builtin_fma(co, r2, 1.0 / 24.0);
    co = __builtin_fma(co, r2, -0.5);
    co = __builtin_fma(co, r2, 1.0);
    const int q = ((int)kd) & 3;
    const double ss = (q == 0) ? s : (q == 1) ? co : (q == 2) ? -s : -co;
    const double cc = (q == 0) ? co : (q == 1) ? -s : (q == 2) ? -co : s;
    cs = (float)cc; sn = (float)ss;
}
__global__ void __launch_bounds__(256) k_rope_tab(const int* __restrict__ pos, float2* __restrict__ tab) {
    const int idx = blockIdx.x * 256 + threadIdx.x; if (idx >= T * 32) return;
    const int t = idx >> 5, i = idx & 31;
    const float inv = (float)exp2(-(double)i * (13.287712379549449 / 32.0));
    const float ang = (float)pos[t] * inv;
    float cs, sn; sincos_f32arg(ang, cs, sn);
    tab[idx] = make_float2(cs, sn);
}

__device__ __forceinline__ float wave_sum(float v) {
#pragma unroll
    for (int o = 1; o < 64; o <<= 1) v += __shfl_xor(v, o);
    return v;
}
__global__ void __launch_bounds__(256) k_h1(const float* __restrict__ x, const float* __restrict__ g, const float* __restrict__ mod, int sh_off, int sc_off, bf16_t* __restrict__ out) {
    const int row = blockIdx.x * 4 + (threadIdx.x >> 6), lane = threadIdx.x & 63, b = row / SEQ;
    const float4* xr = (const float4*)(x + (size_t)row * DM) + lane;
    float4 v[4]; float s = 0.f;
#pragma unroll
    for (int j = 0; j < 4; ++j) { v[j] = xr[64 * j]; s += v[j].x * v[j].x + v[j].y * v[j].y + v[j].z * v[j].z + v[j].w * v[j].w; }
    const float rstd = rsqrtf(wave_sum(s) * (1.f / DM) + EPS);
    const float* sh = mod + b * 6144 + sh_off; const float* sc = mod + b * 6144 + sc_off;
#pragma unroll
    for (int j = 0; j < 4; ++j) {
        const int c0 = 4 * lane + 256 * j;
        const float4 gg = *(const float4*)(g + c0), s4 = *(const float4*)(sc + c0), h4 = *(const float4*)(sh + c0);
        ushort4 o;
        o.x = f2bf(v[j].x * rstd * gg.x * (1.f + s4.x) + h4.x); o.y = f2bf(v[j].y * rstd * gg.y * (1.f + s4.y) + h4.y);
        o.z = f2bf(v[j].z * rstd * gg.z * (1.f + s4.z) + h4.z); o.w = f2bf(v[j].w * rstd * gg.w * (1.f + s4.w) + h4.w);
        *(ushort4*)(out + (size_t)row * DM + c0) = o;
    }
}

__device__ __forceinline__ float rstd8(const float* ss, float invn) {
    const float4 a = *(const float4*)ss, b = *(const float4*)(ss + 4);
    return rsqrtf(((a.x + a.y) + (a.z + a.w) + (b.x + b.y) + (b.z + b.w)) * invn + EPS);
}
struct ALBf16 { const bf16_t* A; long lda; __device__ float operator()(int m, int k) const { return bf2f(A[(size_t)m * lda + k]); } };
struct ALBf16Gain { const bf16_t* A; long lda; const float* g; __device__ float operator()(int m, int k) const { return bf2f(A[(size_t)m * lda + k]) * g[k]; } };
struct ALY { const bf16_t* Y; const float* sso; const float* g; __device__ float operator()(int m, int k) const {
    float v = bf2f(Y[(size_t)m * 1024 + k]); if (k < 512) v *= rstd8(sso + (size_t)m * 8, 1.f / 512.f) * g[k]; return v; } };
struct EpBf16 { bf16_t* C; long ldc; __device__ void operator()(int m, int n, float v) const { C[(size_t)m * ldc + n] = f2bf(v); } };
struct EpF32 { float* C; long ldc; __device__ void operator()(int m, int n, float v) const { C[(size_t)m * ldc + n] = v; } };
struct EpQ { bf16_t* Q; const float* ss; __device__ void operator()(int m, int n, float v) const { Q[(size_t)m * 768 + n] = f2bf(v * rstd8(ss + (size_t)m * 8, 1.f / 384.f)); } };
struct EpKV { bf16_t* K; bf16_t* V; const float* ss; __device__ void operator()(int m, int n, float v) const {
    v *= rstd8(ss + (size_t)m * 8, 1.f / 256.f); const int h = n >> 7, j = n & 127;
    if (j < 64) K[(size_t)m * 768 + h * 96 + j] = f2bf(v); else V[(size_t)m * 512 + h * 64 + (j - 64)] = f2bf(v); } };

template <class AL, class EP>
__global__ void __launch_bounds__(256) k_ngemm(int N, int K, const float* __restrict__ W, int ldw, AL al, EP ep) {
    __shared__ float As[16][68];
    __shared__ float Bs[16][68];
    const int tx = threadIdx.x & 15, ty = threadIdx.x >> 4;
    const int m0 = blockIdx.y * 64, n0 = blockIdx.x * 64;
    float acc[4][4];
#pragma unroll
    for (int i = 0; i < 4; ++i)
#pragma unroll
        for (int j = 0; j < 4; ++j) acc[i][j] = 0.f;
    for (int k0 = 0; k0 < K; k0 += 16) {
#pragma unroll
        for (int i = 0; i < 4; ++i) { const int e = threadIdx.x + i * 256, m = e >> 4, k = e & 15; As[k][m] = al(m0 + m, k0 + k); }
#pragma unroll
        for (int i = 0; i < 4; ++i) { const int e = threadIdx.x + i * 256, k = e >> 6, n = e & 63; Bs[k][n] = (n0 + n < N) ? W[(size_t)(k0 + k) * ldw + n0 + n] : 0.f; }
        __syncthreads();
#pragma unroll
        for (int k = 0; k < 16; ++k) {
            const float4 a = *(const float4*)&As[k][ty * 4], b = *(const float4*)&Bs[k][tx * 4];
            const float av[4] = {a.x, a.y, a.z, a.w}, bv[4] = {b.x, b.y, b.z, b.w};
#pragma unroll
            for (int i = 0; i < 4; ++i)
#pragma unroll
                for (int j = 0; j < 4; ++j) acc[i][j] = fmaf(av[i], bv[j], acc[i][j]);
        }
        __syncthreads();
    }
#pragma unroll
    for (int i = 0; i < 4; ++i)
#pragma unroll
        for (int j = 0; j < 4; ++j) if (n0 + tx * 4 + j < N) ep(m0 + ty * 4 + i, n0 + tx * 4 + j, acc[i][j]);
}
__global__ void __launch_bounds__(256) k_ngemm_gu(int N, int K, const float* __restrict__ Wg, const float* __restrict__ Wu, const bf16_t* __restrict__ A, bf16_t* __restrict__ C) {
    __shared__ float As[16][68];
    __shared__ float Bg[16][68];
    __shared__ float Bu[16][68];
    const int tx = threadIdx.x & 15, ty = threadIdx.x >> 4;
    const int m0 = blockIdx.y * 64, n0 = blockIdx.x * 64;
    float ag[4][4], au[4][4];
#pragma unroll
    for (int i = 0; i < 4; ++i)
#pragma unroll
        for (int j = 0; j < 4; ++j) { ag[i][j] = 0.f; au[i][j] = 0.f; }
    for (int k0 = 0; k0 < K; k0 += 16) {
#pragma unroll
        for (int i = 0; i < 4; ++i) { const int e = threadIdx.x + i * 256, m = e >> 4, k = e & 15; As[k][m] = bf2f(A[(size_t)(m0 + m) * K + k0 + k]); }
#pragma unroll
        for (int i = 0; i < 4; ++i) { const int e = threadIdx.x + i * 256, k = e >> 6, n = e & 63;
            Bg[k][n] = Wg[(size_t)(k0 + k) * N + n0 + n]; Bu[k][n] = Wu[(size_t)(k0 + k) * N + n0 + n]; }
        __syncthreads();
#pragma unroll
        for (int k = 0; k < 16; ++k) {
            const float4 a = *(const float4*)&As[k][ty * 4], b = *(const float4*)&Bg[k][tx * 4], c = *(const float4*)&Bu[k][tx * 4];
            const float av[4] = {a.x, a.y, a.z, a.w}, bv[4] = {b.x, b.y, b.z, b.w}, cv[4] = {c.x, c.y, c.z, c.w};
#pragma unroll
            for (int i = 0; i < 4; ++i)
#pragma unroll
                for (int j = 0; j < 4; ++j) { ag[i][j] = fmaf(av[i], bv[j], ag[i][j]); au[i][j] = fmaf(av[i], cv[j], au[i][j]); }
        }
        __syncthreads();
    }
#pragma unroll
    for (int i = 0; i < 4; ++i)
#pragma unroll
        for (int j = 0; j < 4; ++j) { const float g = ag[i][j]; C[(size_t)(m0 + ty * 4 + i) * N + n0 + tx * 4 + j] = f2bf(g / (1.f + expf(-g)) * au[i][j]); }
}

__global__ void __launch_bounds__(256) k_sumsq(const bf16_t* __restrict__ A, int n, float* __restrict__ ss) {
    const int row = blockIdx.x * 4 + (threadIdx.x >> 6), lane = threadIdx.x & 63;
    float s = 0.f; for (int k = lane; k < n; k += 64) { const float v = bf2f(A[(size_t)row * n + k]); s += v * v; }
    s = wave_sum(s);
    if (lane < 8) ss[(size_t)row * 8 + lane] = (lane == 0) ? s : 0.f;
}
__global__ void __launch_bounds__(256) k_rope_inplace(bf16_t* __restrict__ A, int nh, int d, int fs, float scale, const float2* __restrict__ tab) {
    const int idx = blockIdx.x * 256 + threadIdx.x; const int half = d / 2, per = nh * half;
    if (idx >= T * per) return;
    const int t = idx / per, r = idx % per, h = r / half, i = r % half;
    const float2 cs = tab[t * 32 + i * fs];
    bf16_t* p = A + (size_t)t * nh * d + h * d;
    const float x1 = bf2f(p[i]), x2 = bf2f(p[i + half]);
    p[i] = f2bf((x1 * cs.x - x2 * cs.y) * scale); p[i + half] = f2bf((x1 * cs.y + x2 * cs.x) * scale);
}
__global__ void __launch_bounds__(256) k_kpe(const bf16_t* __restrict__ kpe, bf16_t* __restrict__ K, const float2* __restrict__ tab) {
    const int idx = blockIdx.x * 256 + threadIdx.x; if (idx >= T * 16) return;
    const int t = idx >> 4, i = idx & 15;
    const float2 cs = tab[t * 32 + 2 * i];
    const float x1 = bf2f(kpe[t * 32 + i]), x2 = bf2f(kpe[t * 32 + 16 + i]);
    const bf16_t a = f2bf(x1 * cs.x - x2 * cs.y), b = f2bf(x1 * cs.y + x2 * cs.x);
#pragma unroll
    for (int h = 0; h < 8; ++h) { K[(size_t)t * 768 + h * 96 + 64 + i] = a; K[(size_t)t * 768 + h * 96 + 80 + i] = b; }
}
__global__ void __launch_bounds__(256) k_qfin(bf16_t* __restrict__ Q, const float2* __restrict__ tab) {
    const int idx = blockIdx.x * 256 + threadIdx.x; if (idx >= T * 8 * 48) return;
    const int t = idx / 384, r = idx % 384, h = r / 48, i = r % 48;
    bf16_t* p = Q + (size_t)t * 768 + h * 96;
    if (i < 32) { p[2 * i] = f2bf(bf2f(p[2 * i]) * QSCALE); p[2 * i + 1] = f2bf(bf2f(p[2 * i + 1]) * QSCALE); }
    else { const int j = i - 32; const float2 cs = tab[t * 32 + 2 * j]; const float x1 = bf2f(p[64 + j]), x2 = bf2f(p[80 + j]);
        p[64 + j] = f2bf((x1 * cs.x - x2 * cs.y) * QSCALE); p[80 + j] = f2bf((x1 * cs.y + x2 * cs.x) * QSCALE); }
}

__global__ void __launch_bounds__(256) k_nattn(const bf16_t* __restrict__ Q, const bf16_t* __restrict__ K, const bf16_t* __restrict__ V, bf16_t* __restrict__ Y, float* __restrict__ sso) {
    __shared__ float Ks[32][96];
    __shared__ float Vs[32][64];
    const int qb = 15 - (int)blockIdx.x, h = blockIdx.y, b = blockIdx.z;
    const int qi = qb * 256 + threadIdx.x; const size_t trow = (size_t)b * SEQ + qi;
    float q[96];
#pragma unroll
    for (int d = 0; d < 96; ++d) q[d] = bf2f(Q[trow * 768 + h * 96 + d]);
    float o[64];
#pragma unroll
    for (int d = 0; d < 64; ++d) o[d] = 0.f;
    float m = -1e30f, l = 0.f;
    const int nk = qb * 256 + 256;
    for (int k0 = 0; k0 < nk; k0 += 32) {
        __syncthreads();
        for (int e = threadIdx.x; e < 32 * 96; e += 256) { const int r = e / 96, d = e % 96; Ks[r][d] = bf2f(K[((size_t)b * SEQ + k0 + r) * 768 + h * 96 + d]); }
        for (int e = threadIdx.x; e < 32 * 64; e += 256) { const int r = e >> 6, d = e & 63; Vs[r][d] = bf2f(V[((size_t)b * SEQ + k0 + r) * 512 + h * 64 + d]); }
        __syncthreads();
        for (int r = 0; r < 32; ++r) {
            if (k0 + r > qi) break;
            float s = 0.f;
#pragma unroll
            for (int d = 0; d < 96; d += 4) { const float4 kk = *(const float4*)&Ks[r][d]; s = fmaf(q[d], kk.x, s); s = fmaf(q[d + 1], kk.y, s); s = fmaf(q[d + 2], kk.z, s); s = fmaf(q[d + 3], kk.w, s); }
            if (s > m) { const float f = exp2f(m - s); l *= f;
#pragma unroll
                for (int d = 0; d < 64; ++d) o[d] *= f;
                m = s; }
            const float p = exp2f(s - m); l += p;
#pragma unroll
            for (int d = 0; d < 64; d += 4) { const float4 vv = *(const float4*)&Vs[r][d]; o[d] = fmaf(p, vv.x, o[d]); o[d + 1] = fmaf(p, vv.y, o[d + 1]); o[d + 2] = fmaf(p, vv.z, o[d + 2]); o[d + 3] = fmaf(p, vv.w, o[d + 3]); }
        }
    }
    const float il = 1.f / l; float ss = 0.f;
#pragma unroll
    for (int d = 0; d < 64; ++d) { const float v = o[d] * il; ss += v * v; Y[trow * 1024 + h * 64 + d] = f2bf(v); }
    sso[trow * 8 + h] = ss;
}

__global__ void __launch_bounds__(128) k_nret(const bf16_t* __restrict__ RQ, const bf16_t* __restrict__ RK, const bf16_t* __restrict__ RV, float* __restrict__ oret) {
    __shared__ float qs[32][64];
    __shared__ float ks[32][64];
    const int h = blockIdx.x, b = blockIdx.y, j = threadIdx.x;
    const float gamma = 1.f - exp2f(-5.f - (float)h);
    float S[64];
#pragma unroll
    for (int i = 0; i < 64; ++i) S[i] = 0.f;
    for (int t0 = 0; t0 < SEQ; t0 += 32) {
        __syncthreads();
        for (int e = j; e < 32 * 64; e += 128) { const int r = e >> 6, i = e & 63; const size_t row = (size_t)b * SEQ + t0 + r;
            qs[r][i] = bf2f(RQ[row * 256 + h * 64 + i]); ks[r][i] = bf2f(RK[row * 256 + h * 64 + i]); }
        __syncthreads();
        for (int r = 0; r < 32; ++r) {
            const size_t row = (size_t)b * SEQ + t0 + r;
            const float v = bf2f(RV[row * 512 + h * 128 + j]);
            float o = 0.f;
#pragma unroll
            for (int i = 0; i < 64; i += 4) {
                const float4 kk = *(const float4*)&ks[r][i], qq = *(const float4*)&qs[r][i];
                S[i] = fmaf(S[i], gamma, kk.x * v); S[i + 1] = fmaf(S[i + 1], gamma, kk.y * v); S[i + 2] = fmaf(S[i + 2], gamma, kk.z * v); S[i + 3] = fmaf(S[i + 3], gamma, kk.w * v);
                o = fmaf(qq.x, S[i], o); o = fmaf(qq.y, S[i + 1], o); o = fmaf(qq.z, S[i + 2], o); o = fmaf(qq.w, S[i + 3], o);
            }
            oret[row * 512 + h * 128 + j] = o;
        }
    }
}
__global__ void __launch_bounds__(256) k_gn_gate(const float* __restrict__ oret, const bf16_t* __restrict__ RG, const float* __restrict__ gain, bf16_t* __restrict__ Y) {
    const int row = blockIdx.x * 4 + (threadIdx.x >> 6), lane = threadIdx.x & 63, c0 = lane * 8;
    float v[8]; float s = 0.f;
#pragma unroll
    for (int i = 0; i < 8; ++i) { v[i] = oret[(size_t)row * 512 + c0 + i]; s += v[i]; }
#pragma unroll
    for (int o = 1; o < 16; o <<= 1) s += __shfl_xor(s, o);
    const float mu = s * (1.f / 128.f); float q = 0.f;
#pragma unroll
    for (int i = 0; i < 8; ++i) { v[i] -= mu; q += v[i] * v[i]; }
#pragma unroll
    for (int o = 1; o < 16; o <<= 1) q += __shfl_xor(q, o);
    const float rstd = rsqrtf(q * (1.f / 128.f) + EPS);
#pragma unroll
    for (int i = 0; i < 8; ++i) { const float g = bf2f(RG[(size_t)row * 512 + c0 + i]); Y[(size_t)row * 1024 + 512 + c0 + i] = f2bf(g / (1.f + expf(-g)) * (v[i] * rstd * gain[c0 + i])); }
}

__global__ void __launch_bounds__(256) k_post1(const float* __restrict__ x, const float* __restrict__ mix, const float* __restrict__ mod, const float* __restrict__ pn, const float* __restrict__ pf, float* __restrict__ out, bf16_t* __restrict__ h2) {
    const int row = blockIdx.x * 4 + (threadIdx.x >> 6), lane = threadIdx.x & 63, b = row / SEQ;
    const float* md = mod + b * 6144;
    float4 mv[4], xv[4]; float s = 0.f;
#pragma unroll
    for (int j = 0; j < 4; ++j) { mv[j] = *((const float4*)(mix + (size_t)row * DM) + lane + 64 * j); s += mv[j].x * mv[j].x + mv[j].y * mv[j].y + mv[j].z * mv[j].z + mv[j].w * mv[j].w; }
    const float r1 = rsqrtf(wave_sum(s) * (1.f / DM) + EPS); float s2 = 0.f;
#pragma unroll
    for (int j = 0; j < 4; ++j) { const int c0 = 4 * lane + 256 * j; const float4 xx = *(const float4*)(x + (size_t)row * DM + c0), g1 = *(const float4*)(md + 2048 + c0), p = *(const float4*)(pn + c0);
        xv[j].x = xx.x + g1.x * (mv[j].x * r1 * p.x); xv[j].y = xx.y + g1.y * (mv[j].y * r1 * p.y); xv[j].z = xx.z + g1.z * (mv[j].z * r1 * p.z); xv[j].w = xx.w + g1.w * (mv[j].w * r1 * p.w);
        *(float4*)(out + (size_t)row * DM + c0) = xv[j]; s2 += xv[j].x * xv[j].x + xv[j].y * xv[j].y + xv[j].z * xv[j].z + xv[j].w * xv[j].w; }
    const float r2 = rsqrtf(wave_sum(s2) * (1.f / DM) + EPS);
#pragma unroll
    for (int j = 0; j < 4; ++j) { const int c0 = 4 * lane + 256 * j; const float4 p = *(const float4*)(pf + c0), sc = *(const float4*)(md + 4096 + c0), sh = *(const float4*)(md + 3072 + c0);
        ushort4 o; o.x = f2bf(xv[j].x * r2 * p.x * (1.f + sc.x) + sh.x); o.y = f2bf(xv[j].y * r2 * p.y * (1.f + sc.y) + sh.y); o.z = f2bf(xv[j].z * r2 * p.z * (1.f + sc.z) + sh.z); o.w = f2bf(xv[j].w * r2 * p.w * (1.f + sc.w) + sh.w);
        *(ushort4*)(h2 + (size_t)row * DM + c0) = o; }
}
__global__ void __launch_bounds__(256) k_post2(const float* __restrict__ f, const float* __restrict__ mod, const float* __restrict__ pnf, float* __restrict__ out) {
    const int row = blockIdx.x * 4 + (threadIdx.x >> 6), lane = threadIdx.x & 63, b = row / SEQ;
    const float* md = mod + b * 6144;
    float4 fv[4]; float s = 0.f;
#pragma unroll
    for (int j = 0; j < 4; ++j) { fv[j] = *((const float4*)(f + (size_t)row * DM) + lane + 64 * j); s += fv[j].x * fv[j].x + fv[j].y * fv[j].y + fv[j].z * fv[j].z + fv[j].w * fv[j].w; }
    const float r1 = rsqrtf(wave_sum(s) * (1.f / DM) + EPS);
#pragma unroll
    for (int j = 0; j < 4; ++j) { const int c0 = 4 * lane + 256 * j; float4 xx = *(const float4*)(out + (size_t)row * DM + c0); const float4 g2 = *(const float4*)(md + 5120 + c0), p = *(const float4*)(pnf + c0);
        xx.x += g2.x * (fv[j].x * r1 * p.x); xx.y += g2.y * (fv[j].y * r1 * p.y); xx.z += g2.z * (fv[j].z * r1 * p.z); xx.w += g2.w * (fv[j].w * r1 * p.w);
        *(float4*)(out + (size_t)row * DM + c0) = xx; }
}

extern "C" void kernel_launch(void* const* d_in, const int* in_sizes, int n_in, void* d_out, int out_size, void* d_ws, size_t ws_size, hipStream_t stream) {
    if (n_in != 20 || in_sizes[0] != T * DM || out_size != T * DM || ws_size < WS_END) { fprintf(stderr, "kernel_launch: unexpected shapes (n_in %d, ws %zu)\n", n_in, ws_size); return; }
    const float* x = (const float*)d_in[0]; const float* c = (const float*)d_in[1]; const int* pos = (const int*)d_in[2];
    const float* w_ada = (const float*)d_in[3]; const float* b_ada = (const float*)d_in[4]; const float* pn_mix = (const float*)d_in[5];
    const float* w_in = (const float*)d_in[6]; const float* qan = (const float*)d_in[7]; const float* w_qb = (const float*)d_in[8];
    const float* kvan = (const float*)d_in[9]; const float* w_kvb = (const float*)d_in[10]; const float* mla_on = (const float*)d_in[11];
    const float* gn_gain = (const float*)d_in[12]; const float* w_out = (const float*)d_in[13]; const float* post_mix = (const float*)d_in[14];
    const float* pre_ffn = (const float*)d_in[15]; const float* w_gate = (const float*)d_in[16]; const float* w_up = (const float*)d_in[17];
    const float* w_down = (const float*)d_in[18]; const float* post_ffn = (const float*)d_in[19];
    float* out = (float*)d_out; unsigned char* ws = (unsigned char*)d_ws;
    float* mod = (float*)(ws + WS_MOD); float2* tab = (float2*)(ws + WS_ROPE);
    float* sscq = (float*)(ws + WS_SSCQ); float* ssckv = (float*)(ws + WS_SSCKV); float* sso = (float*)(ws + WS_SSO);
    bf16_t* H = (bf16_t*)(ws + WS_H); bf16_t* Y = (bf16_t*)(ws + WS_Y); bf16_t* ACT = (bf16_t*)(ws + WS_ACT);
    bf16_t* CQ = (bf16_t*)(ws + WS_CQ); bf16_t* CKV = (bf16_t*)(ws + WS_CKV); bf16_t* RQ = (bf16_t*)(ws + WS_RQ); bf16_t* RK = (bf16_t*)(ws + WS_RK);
    bf16_t* RV = (bf16_t*)(ws + WS_RV); bf16_t* RG = (bf16_t*)(ws + WS_RG); bf16_t* Q = (bf16_t*)(ws + WS_Q); bf16_t* K = (bf16_t*)(ws + WS_K); bf16_t* V = (bf16_t*)(ws + WS_V);
    bf16_t* KPE = (bf16_t*)(ws + WS_KPE); float* ORET = (float*)(ws + WS_H); float* MIXT = (float*)(ws + WS_MIXTMP); float* FT = (float*)(ws + WS_FTMP);

    k_mod<<<dim3(6144 / 256, 8), 256, 0, stream>>>(c, w_ada, b_ada, mod);
    k_rope_tab<<<T * 32 / 256, 256, 0, stream>>>(pos, tab);
    k_h1<<<T / 4, 256, 0, stream>>>(x, pn_mix, mod, 0, 1024, H);
    k_ngemm<<<dim3(6, T / 64), 256, 0, stream>>>(384, 1024, w_in + 0, INC, ALBf16{H, 1024}, EpBf16{CQ, 384});
    k_ngemm<<<dim3(4, T / 64), 256, 0, stream>>>(256, 1024, w_in + 384, INC, ALBf16{H, 1024}, EpBf16{CKV, 256});
    k_ngemm<<<dim3(1, T / 64), 256, 0, stream>>>(32, 1024, w_in + 640, INC, ALBf16{H, 1024}, EpBf16{KPE, 32});
    k_ngemm<<<dim3(4, T / 64), 256, 0, stream>>>(256, 1024, w_in + 672, INC, ALBf16{H, 1024}, EpBf16{RQ, 256});
    k_ngemm<<<dim3(4, T / 64), 256, 0, stream>>>(256, 1024, w_in + 928, INC, ALBf16{H, 1024}, EpBf16{RK, 256});
    k_ngemm<<<dim3(8, T / 64), 256, 0, stream>>>(512, 1024, w_in + 1184, INC, ALBf16{H, 1024}, EpBf16{RV, 512});
    k_ngemm<<<dim3(8, T / 64), 256, 0, stream>>>(512, 1024, w_in + 1696, INC, ALBf16{H, 1024}, EpBf16{RG, 512});
    k_sumsq<<<T / 4, 256, 0, stream>>>(CQ, 384, sscq);
    k_sumsq<<<T / 4, 256, 0, stream>>>(CKV, 256, ssckv);
    k_rope_inplace<<<T * 4 * 32 / 256, 256, 0, stream>>>(RQ, 4, 64, 1, 1.f, tab);
    k_rope_inplace<<<T * 4 * 32 / 256, 256, 0, stream>>>(RK, 4, 64, 1, 0.125f, tab);
    k_kpe<<<T * 16 / 256, 256, 0, stream>>>(KPE, K, tab);
    k_ngemm<<<dim3(12, T / 64), 256, 0, stream>>>(768, 384, w_qb, 768, ALBf16Gain{CQ, 384, qan}, EpQ{Q, sscq});
    k_qfin<<<T * 384 / 256, 256, 0, stream>>>(Q, tab);
    k_ngemm<<<dim3(16, T / 64), 256, 0, stream>>>(1024, 256, w_kvb, 1024, ALBf16Gain{CKV, 256, kvan}, EpKV{K, V, ssckv});
    k_nattn<<<dim3(16, 8, 8), 256, 0, stream>>>(Q, K, V, Y, sso);
    k_nret<<<dim3(4, 8), 128, 0, stream>>>(RQ, RK, RV, ORET);
    k_gn_gate<<<T / 4, 256, 0, stream>>>(ORET, RG, gn_gain, Y);
    k_ngemm<<<dim3(16, T / 64), 256, 0, stream>>>(1024, 1024, w_out, 1024, ALY{Y, sso, mla_on}, EpF32{MIXT, 1024});
    k_post1<<<T / 4, 256, 0, stream>>>(x, MIXT, mod, post_mix, pre_ffn, out, H);
    k_ngemm_gu<<<dim3(DFF / 64, T / 64), 256, 0, stream>>>(DFF, 1024, w_gate, w_up, H, ACT);
    k_ngemm<<<dim3(16, T / 64), 256, 0, stream>>>(1024, DFF, w_down, 1024, ALBf16{ACT, DFF}, EpF32{FT, 1024});
    k_post2<<<T / 4, 256, 0, stream>>>(FT, mod, post_ffn, out);
}
```
